# Optimizing an MI355X kernel written in HIP

```python
import jax, jax.numpy as jnp
from jax import lax
import numpy as np

D_MODEL = 1024
BATCH = 16
SEQ = 2048
DEPTH = 1

N_META = 16
D_MIX = D_MODEL
D_CONV = D_MIX // 2
CONV_WIDTH = 31
GLA_HEADS = 4
GLA_DV = (D_MIX - D_CONV) // GLA_HEADS
GLA_DK = GLA_DV // 2
GLA_GATE_RANK = 16
GLA_TAU = 16.0
CHUNK = 64
D_FF = 4 * D_MODEL
LN_EPS = 1e-5
DEEPNORM_ALPHA = (2.0 * DEPTH) ** 0.25
DEEPNORM_BETA = (8.0 * DEPTH) ** -0.25

SPLIT_SIZES = (D_CONV, D_CONV,
               GLA_HEADS * GLA_DK, GLA_HEADS * GLA_DK,
               GLA_HEADS * GLA_DV, GLA_HEADS * GLA_DV,
               GLA_GATE_RANK)
D_IN = sum(SPLIT_SIZES)
SPLIT_IDX = tuple(int(i) for i in np.cumsum(SPLIT_SIZES)[:-1])

kernel_name = "hymba_conformer_gla_deepnorm"


def layer_norm(x, g, b):
    xf = x.astype(jnp.float32)
    mu = jnp.mean(xf, axis=-1, keepdims=True)
    var = jnp.mean(jnp.square(xf - mu), axis=-1, keepdims=True)
    y = (xf - mu) * lax.rsqrt(var + LN_EPS)
    return (y * g.astype(jnp.float32) + b.astype(jnp.float32)).astype(x.dtype)


def rms_norm(x, g):
    xf = x.astype(jnp.float32)
    y = xf * lax.rsqrt(jnp.mean(jnp.square(xf), axis=-1, keepdims=True) + LN_EPS)
    return y * g.astype(jnp.float32)


def conformer_conv(a, gate, conv_w, conv_b, ln_g, ln_b):
    h = a * jax.nn.sigmoid(gate)
    h = lax.conv_general_dilated(
        h, conv_w[:, None, :].astype(h.dtype),
        window_strides=(1,), padding=[(CONV_WIDTH - 1, 0)],
        dimension_numbers=("NWC", "WIO", "NWC"),
        feature_group_count=D_CONV) + conv_b
    return jax.nn.silu(layer_norm(h, ln_g, ln_b))


def gla_chunked(q, k, v, log_g):
    B, T = q.shape[0], q.shape[1]
    pad = (-N_META) % CHUNK
    padw = ((0, 0), (pad, 0), (0, 0), (0, 0))
    q, k, v, log_g = [jnp.pad(t.astype(jnp.float32), padw) for t in (q, k, v, log_g)]
    L = T + pad
    N = L // CHUNK

    def to_chunks(t):
        return t.reshape(B, N, CHUNK, GLA_HEADS, t.shape[-1]).transpose(0, 3, 1, 2, 4)

    q, k, v, log_g = map(to_chunks, (q, k, v, log_g))
    q = q * (GLA_DK ** -0.5)
    b = jnp.cumsum(log_g, axis=3)
    b_last = b[:, :, :, -1:, :]
    qe = q * jnp.exp(b)
    ke = k * jnp.exp(-b)
    kd = k * jnp.exp(b_last - b)

    mask = jnp.tril(jnp.ones((CHUNK, CHUNK), dtype=bool))
    A = jnp.einsum("bhncd,bhnsd->bhncs", qe, ke)
    A = jnp.where(mask, A, 0.0)
    o_intra = jnp.einsum("bhncs,bhnse->bhnce", A, v)

    dS = jnp.einsum("bhncd,bhnce->bhnde", kd, v)
    decay = jnp.exp(b_last[:, :, :, 0, :])

    def step(S, xs):
        dec, upd = xs
        return dec[..., None] * S + upd, S

    S0 = jnp.zeros((B, GLA_HEADS, GLA_DK, GLA_DV), jnp.float32)
    _, S_before = lax.scan(step, S0, (jnp.moveaxis(decay, 2, 0), jnp.moveaxis(dS, 2, 0)))
    S_before = jnp.moveaxis(S_before, 0, 2)
    o_inter = jnp.einsum("bhncd,bhnde->bhnce", qe, S_before)

    o = (o_intra + o_inter).transpose(0, 2, 3, 1, 4).reshape(B, L, GLA_HEADS, GLA_DV)
    return o[:, pad:]


def setup_inputs(seed: int = 0) -> dict:
    key = jax.random.key(seed)
    ks = jax.random.split(key, 20)
    f32 = jnp.float32

    def nrm(k, shape, scale):
        return jax.random.normal(k, shape, f32) * scale

    def gain(k, shape):
        return 1.0 + 0.02 * jax.random.normal(k, shape, f32)

    return {
        "x": jax.random.normal(ks[0], (BATCH, SEQ, D_MODEL), f32),
        "meta_tokens": nrm(ks[1], (N_META, D_MODEL), 1.0),
        "ln_in_g": gain(ks[2], (D_MODEL,)),
        "ln_in_b": nrm(ks[3], (D_MODEL,), 0.02),
        "w_in": nrm(ks[4], (DEPTH, D_MODEL, D_IN), D_MODEL ** -0.5),
        "conv_w": nrm(ks[5], (DEPTH, CONV_WIDTH, D_CONV), CONV_WIDTH ** -0.5),
        "conv_b": nrm(ks[6], (DEPTH, D_CONV), 0.02),
        "conv_ln_g": gain(ks[7], (DEPTH, D_CONV)),
        "conv_ln_b": nrm(ks[8], (DEPTH, D_CONV), 0.02),
        "gate_up": nrm(ks[9], (DEPTH, GLA_GATE_RANK, GLA_HEADS * GLA_DK), GLA_GATE_RANK ** -0.5),
        "gate_bias": nrm(ks[10], (DEPTH, GLA_HEADS * GLA_DK), 0.02),
        "gla_norm_g": gain(ks[11], (DEPTH, GLA_DV)),
        "w_out": nrm(ks[12], (DEPTH, D_MIX, D_MODEL), DEEPNORM_BETA * D_MIX ** -0.5),
        "ln1_g": gain(ks[13], (DEPTH, D_MODEL)),
        "ln1_b": nrm(ks[14], (DEPTH, D_MODEL), 0.02),
        "w_ff1": nrm(ks[15], (DEPTH, D_MODEL, D_FF), D_MODEL ** -0.5),
        "w_ff2": nrm(ks[16], (DEPTH, D_FF, D_MODEL), DEEPNORM_BETA * D_FF ** -0.5),
        "ln2_g": gain(ks[17], (DEPTH, D_MODEL)),
        "ln2_b": nrm(ks[18], (DEPTH, D_MODEL), 0.02),
    }


def reference(x, meta_tokens, ln_in_g, ln_in_b, w_in, conv_w, conv_b, conv_ln_g, conv_ln_b,
              gate_up, gate_bias, gla_norm_g, w_out, ln1_g, ln1_b, w_ff1, w_ff2, ln2_g, ln2_b):
    B = x.shape[0]
    meta = jnp.broadcast_to(meta_tokens.astype(x.dtype)[None], (B, N_META, D_MODEL))
    s = jnp.concatenate([meta, x], axis=1)
    s = layer_norm(s, ln_in_g, ln_in_b)
    T = s.shape[1]

    for l in range(DEPTH):
        u = s @ w_in[l]
        c_val, c_gate, q, k, v, r, g_down = jnp.split(u, SPLIT_IDX, axis=-1)

        conv_out = conformer_conv(c_val, c_gate, conv_w[l], conv_b[l], conv_ln_g[l], conv_ln_b[l])

        z = (g_down @ gate_up[l] + gate_bias[l]).astype(jnp.float32)
        log_g = jax.nn.log_sigmoid(z) / GLA_TAU
        hd = lambda t, d: t.reshape(B, T, GLA_HEADS, d)
        o = gla_chunked(hd(q, GLA_DK), hd(k, GLA_DK), hd(v, GLA_DV), hd(log_g, GLA_DK))
        o = rms_norm(o, gla_norm_g[l]) * jax.nn.silu(hd(r, GLA_DV).astype(jnp.float32))
        gla_out = o.reshape(B, T, GLA_HEADS * GLA_DV).astype(s.dtype)

        mix = jnp.concatenate([conv_out, gla_out], axis=-1) @ w_out[l]
        s = layer_norm(DEEPNORM_ALPHA * s + mix, ln1_g[l], ln1_b[l])

        f = jnp.square(jax.nn.relu(s @ w_ff1[l])) @ w_ff2[l]
        s = layer_norm(DEEPNORM_ALPHA * s + f, ln2_g[l], ln2_b[l])

    return s[:, N_META:]
```

```cpp
#include <hip/hip_runtime.h>
#include <stdint.h>

namespace nv {
constexpr int B = 16, SEQ = 2048, NMETA = 16, T = SEQ + NMETA, D = 1024, DIN = 2576, DCONV = 512, CW = 31, NH = 4, DK = 64, DV = 128, RANK = 16, DFF = 4096;
constexpr int MT = B * T;
constexpr float EPS = 1e-5f;
constexpr float ALPHA = 1.189207115002721f;

__device__ __forceinline__ float wave_sum(float v) {
#pragma unroll
    for (int o = 1; o < 64; o <<= 1) v += __shfl_xor(v, o);
    return v;
}
__device__ __forceinline__ float sigmoidf_(float x) { return 1.f / (1.f + __expf(-x)); }

__global__ __launch_bounds__(256) void ln_in_kernel(const float* __restrict__ x, const float* __restrict__ meta, const float* __restrict__ g, const float* __restrict__ bb, float* __restrict__ s0) {
    const int row = blockIdx.x * 4 + (threadIdx.x >> 6), lane = threadIdx.x & 63;
    if (row >= MT) return;
    const int b = row / T, t = row % T;
    const float* src = t < NMETA ? meta + (size_t)t * D : x + ((size_t)b * SEQ + (t - NMETA)) * D;
    float v[16]; float s = 0.f;
#pragma unroll
    for (int j = 0; j < 16; ++j) { v[j] = src[lane + 64 * j]; s += v[j]; }
    const float mean = wave_sum(s) * (1.f / D); float q = 0.f;
#pragma unroll
    for (int j = 0; j < 16; ++j) { v[j] -= mean; q += v[j] * v[j]; }
    const float rstd = rsqrtf(wave_sum(q) * (1.f / D) + EPS);
#pragma unroll
    for (int j = 0; j < 16; ++j) s0[(size_t)row * D + lane + 64 * j] = v[j] * rstd * g[lane + 64 * j] + bb[lane + 64 * j];
}
template <bool TO_OUT>
__global__ __launch_bounds__(256) void ln_rows_kernel(float* __restrict__ s, const float* __restrict__ g, const float* __restrict__ bb, float* __restrict__ out) {
    const int row = blockIdx.x * 4 + (threadIdx.x >> 6), lane = threadIdx.x & 63;
    if (row >= MT) return;
    const int b = row / T, t = row % T;
    if (TO_OUT && t < NMETA) return;
    float v[16]; float sm = 0.f;
#pragma unroll
    for (int j = 0; j < 16; ++j) { v[j] = s[(size_t)row * D + lane + 64 * j]; sm += v[j]; }
    const float mean = wave_sum(sm) * (1.f / D); float q = 0.f;
#pragma unroll
    for (int j = 0; j < 16; ++j) { v[j] -= mean; q += v[j] * v[j]; }
    const float rstd = rsqrtf(wave_sum(q) * (1.f / D) + EPS);
    float* dst = TO_OUT ? out + ((size_t)b * SEQ + (t - NMETA)) * D : s + (size_t)row * D;
#pragma unroll
    for (int j = 0; j < 16; ++j) dst[lane + 64 * j] = v[j] * rstd * g[lane + 64 * j] + bb[lane + 64 * j];
}

template <int EPI>
__global__ __launch_bounds__(256) void gemm_f32(const float* __restrict__ A, int lda, const float* __restrict__ Bm, int ldb, float* C, int ldc, int M, int N, int K, float alpha) {
    __shared__ float As[16][68];
    __shared__ float Bs[16][68];
    const int tid = threadIdx.x, tx = tid & 15, ty = tid >> 4;
    const int m0 = blockIdx.y * 64, n0 = blockIdx.x * 64;
    float acc[4][4];
#pragma unroll
    for (int i = 0; i < 4; ++i)
#pragma unroll
        for (int j = 0; j < 4; ++j) acc[i][j] = 0.f;
    const int arow = tid >> 2, akq = tid & 3;
    const int bk = tid >> 4, bnq = tid & 15;
    for (int k0 = 0; k0 < K; k0 += 16) {
        const float4 a = *(const float4*)(A + (size_t)(m0 + arow) * lda + k0 + akq * 4);
        float4 b = make_float4(0.f, 0.f, 0.f, 0.f);
        if (n0 + bnq * 4 < N) b = *(const float4*)(Bm + (size_t)(k0 + bk) * ldb + n0 + bnq * 4);
        As[akq * 4 + 0][arow] = a.x; As[akq * 4 + 1][arow] = a.y; As[akq * 4 + 2][arow] = a.z; As[akq * 4 + 3][arow] = a.w;
        *(float4*)&Bs[bk][bnq * 4] = b;
        __syncthreads();
#pragma unroll
        for (int k = 0; k < 16; ++k) {
            const float4 av = *(const float4*)&As[k][ty * 4];
            const float4 bv = *(const float4*)&Bs[k][tx * 4];
            const float aa[4] = {av.x, av.y, av.z, av.w}, bbv[4] = {bv.x, bv.y, bv.z, bv.w};
#pragma unroll
            for (int i = 0; i < 4; ++i)
#pragma unroll
                for (int j = 0; j < 4; ++j) acc[i][j] = fmaf(aa[i], bbv[j], acc[i][j]);
        }
        __syncthreads();
    }
#pragma unroll
    for (int i = 0; i < 4; ++i) {
        const int r = m0 + ty * 4 + i;
#pragma unroll
        for (int j = 0; j < 4; ++j) {
            const int c = n0 + tx * 4 + j;
            if (c < N) {
                float v = acc[i][j];
                if (EPI == 1) { v = v > 0.f ? v : 0.f; v = v * v; }
                if (EPI == 2) v = alpha * C[(size_t)r * ldc + c] + v;
                C[(size_t)r * ldc + c] = v;
            }
        }
    }
}

__global__ __launch_bounds__(512) void conv_kernel(const float* __restrict__ u, const float* __restrict__ cw, const float* __restrict__ cb, const float* __restrict__ lg, const float* __restrict__ lb,
                                                   float* __restrict__ mixin, int row_base) {
    __shared__ float red[16];
    const int lrow = blockIdx.x, c = threadIdx.x, t = lrow % T;
    float acc = cb[c];
    for (int j = 0; j < CW; ++j) {
        const int tt = t - (CW - 1) + j;
        if (tt >= 0) {
            const float* ur = u + (size_t)(lrow - (CW - 1) + j) * DIN;
            const float a = ur[c], gt = ur[DCONV + c];
            acc = fmaf(cw[j * DCONV + c], a * sigmoidf_(gt), acc);
        }
    }
    const int w = c >> 6, lane = c & 63;
    float s = wave_sum(acc);
    if (lane == 0) red[w] = s;
    __syncthreads();
    float tot = 0.f;
#pragma unroll
    for (int i = 0; i < 8; ++i) tot += red[i];
    const float mean = tot * (1.f / DCONV);
    const float d = acc - mean;
    float q = wave_sum(d * d);
    if (lane == 0) red[8 + w] = q;
    __syncthreads();
    float qt = 0.f;
#pragma unroll
    for (int i = 0; i < 8; ++i) qt += red[8 + i];
    const float rstd = rsqrtf(qt * (1.f / DCONV) + EPS);
    const float y = d * rstd * lg[c] + lb[c];
    mixin[(size_t)(row_base + lrow) * D + c] = y * sigmoidf_(y);
}

__global__ __launch_bounds__(128) void gla_kernel(const float* __restrict__ u, const float* __restrict__ gate_up, const float* __restrict__ gate_bias, const float* __restrict__ gn,
                                                  float* __restrict__ mixin, int row_base) {
    __shared__ float qs[DK], ks[DK], gs[DK], red[2];
    const int bl = blockIdx.x / NH, h = blockIdx.x % NH, e = threadIdx.x;
    float S[DK];
#pragma unroll
    for (int d = 0; d < DK; ++d) S[d] = 0.f;
    float gu[RANK]; float gbias = 0.f;
    if (e < DK) {
#pragma unroll
        for (int j = 0; j < RANK; ++j) gu[j] = gate_up[j * (NH * DK) + h * DK + e];
        gbias = gate_bias[h * DK + e];
    } else {
#pragma unroll
        for (int j = 0; j < RANK; ++j) gu[j] = 0.f;
    }
    const float gne = gn[e];
    for (int t = 0; t < T; ++t) {
        const float* ur = u + (size_t)(bl * T + t) * DIN;
        if (e < DK) {
            float z = gbias;
#pragma unroll
            for (int j = 0; j < RANK; ++j) z = fmaf(ur[2560 + j], gu[j], z);
            const float ls = fminf(z, 0.f) - log1pf(expf(-fabsf(z)));
            gs[e] = expf(ls * (1.f / 16.f));
            qs[e] = ur[1024 + h * DK + e] * 0.125f;
            ks[e] = ur[1280 + h * DK + e];
        }
        __syncthreads();
        const float v = ur[1536 + h * DV + e];
        float o = 0.f;
#pragma unroll
        for (int d = 0; d < DK; ++d) { S[d] = fmaf(gs[d], S[d], ks[d] * v); o = fmaf(qs[d], S[d], o); }
        const float ss = wave_sum(o * o);
        if ((e & 63) == 0) red[e >> 6] = ss;
        __syncthreads();
        const float rstd = rsqrtf((red[0] + red[1]) * (1.f / DV) + EPS);
        const float r = ur[2048 + h * DV + e];
        mixin[(size_t)(row_base + bl * T + t) * D + DCONV + h * DV + e] = o * rstd * gne * (r * sigmoidf_(r));
        __syncthreads();
    }
}
}

extern "C" void kernel_launch(void* const* d_in, const int* in_sizes, int n_in, void* d_out, int out_size, void* d_ws, size_t ws_size, hipStream_t stream) {
    using namespace nv;
    const float* x = (const float*)d_in[0];
    const float* meta = (const float*)d_in[1];
    const float* ln_in_g = (const float*)d_in[2];
    const float* ln_in_b = (const float*)d_in[3];
    const float* w_in = (const float*)d_in[4];
    const float* conv_w = (const float*)d_in[5];
    const float* conv_b = (const float*)d_in[6];
    const float* conv_ln_g = (const float*)d_in[7];
    const float* conv_ln_b = (const float*)d_in[8];
    const float* gate_up = (const float*)d_in[9];
    const float* gate_bias = (const float*)d_in[10];
    const float* gla_norm_g = (const float*)d_in[11];
    const float* w_out = (const float*)d_in[12];
    const float* ln1_g = (const float*)d_in[13];
    const float* ln1_b = (const float*)d_in[14];
    const float* w_ff1 = (const float*)d_in[15];
    const float* w_ff2 = (const float*)d_in[16];
    const float* ln2_g = (const float*)d_in[17];
    const float* ln2_b = (const float*)d_in[18];
    float* out = (float*)d_out;

    const size_t SZ_S = (size_t)MT * D * 4;
    constexpr int GB = 4, GROWS = GB * T;
    const size_t SZ_U = (size_t)GROWS * DIN * 4;
    if (ws_size < 2 * SZ_S + SZ_U) return;
    float* s = (float*)d_ws;
    float* mixin = (float*)((char*)d_ws + SZ_S);
    float* ug = (float*)((char*)d_ws + 2 * SZ_S);
    float* hbuf = mixin;

    ln_in_kernel<<<MT / 4, 256, 0, stream>>>(x, meta, ln_in_g, ln_in_b, s);
    for (int g = 0; g < B / GB; ++g) {
        const int rb = g * GROWS;
        gemm_f32<0><<<dim3((DIN + 63) / 64, GROWS / 64), 256, 0, stream>>>(s + (size_t)rb * D, D, w_in, DIN, ug, DIN, GROWS, DIN, D, 0.f);
        conv_kernel<<<GROWS, 512, 0, stream>>>(ug, conv_w, conv_b, conv_ln_g, conv_ln_b, mixin, rb);
        gla_kernel<<<GB * NH, 128, 0, stream>>>(ug, gate_up, gate_bias, gla_norm_g, mixin, rb);
    }
    gemm_f32<2><<<dim3(D / 64, MT / 64), 256, 0, stream>>>(mixin, D, w_out, D, s, D, MT, D, D, ALPHA);
    ln_rows_kernel<false><<<MT / 4, 256, 0, stream>>>(s, ln1_g, ln1_b, nullptr);
    for (int g = 0; g < 4; ++g) {
        const int rb = g * GROWS;
        gemm_f32<1><<<dim3(DFF / 64, GROWS / 64), 256, 0, stream>>>(s + (size_t)rb * D, D, w_ff1, DFF, hbuf, DFF, GROWS, DFF, D, 0.f);
        gemm_f32<2><<<dim3(D / 64, GROWS / 64), 256, 0, stream>>>(hbuf, DFF, w_ff2, D, s + (size_t)rb * D, D, GROWS, D, DFF, ALPHA);
    }
    ln_rows_kernel<true><<<MT / 4, 256, 0, stream>>>(s, ln2_g, ln2_b, out);
}
```
